# Optimizing an MI355X kernel written in HIP

```python
import math
import jax, jax.numpy as jnp
from jax import lax
import numpy as np

D_MODEL = 1024
BATCH = 2
SEQ = 16384
DEPTH = 4

D_MIX = D_MODEL
D_POOL = D_MIX // 2
D_SGU = D_MIX // 2
POOL_WINDOWS = (2, 4, 8, 16)
N_POOL_GROUPS = len(POOL_WINDOWS)
POOL_GROUP_DIM = D_POOL // N_POOL_GROUPS
CHUNK = 128
SGU_HEADS = 4
SGU_HEAD_DIM = D_SGU // SGU_HEADS
D_IN = D_POOL + 2 * D_SGU
D_FF = 2816
CONV_WIDTH = 3
N_MOD = 6
DEEPNORM_ALPHA = (2.0 * DEPTH) ** 0.25
DEEPNORM_BETA = (8.0 * DEPTH) ** -0.25
LN_EPS = 1e-5

kernel_name = "hybrid_pool_sgu_convffn_deepnorm_adaln"


def _layernorm(x, g, b):
    xf = x.astype(jnp.float32)
    mu = jnp.mean(xf, axis=-1, keepdims=True)
    var = jnp.mean(jnp.square(xf - mu), axis=-1, keepdims=True)
    y = (xf - mu) * lax.rsqrt(var + LN_EPS)
    return (y * g.astype(jnp.float32) + b.astype(jnp.float32)).astype(x.dtype)


def _modulate(x, shift, scale):
    return x * (1.0 + scale[:, None, :]) + shift[:, None, :]


def _pool_mixer(a, pool_w, pool_scale):
    B, S, _ = a.shape
    ag = a.reshape(B, S, N_POOL_GROUPS, POOL_GROUP_DIM).astype(jnp.float32)
    cs = jnp.cumsum(ag, axis=1)
    t = jnp.arange(S)
    pooled = []
    for g, w in enumerate(POOL_WINDOWS):
        csg = cs[:, :, g]
        prev = jnp.pad(csg, ((0, 0), (w, 0), (0, 0)))[:, :S]
        cnt = jnp.minimum(t + 1, w).astype(jnp.float32)[None, :, None]
        pooled.append((csg - prev) / cnt)
    pooled = (jnp.stack(pooled, axis=2) - ag).astype(a.dtype)
    mixed = jnp.einsum('bsgc,gcd->bsgd', pooled, pool_w)
    return mixed.reshape(B, S, D_POOL) * pool_scale


def _sgu_mixer(u, v, ln_g, ln_b, sgu_w, sgu_b):
    B, S, _ = v.shape
    u = jax.nn.gelu(u)
    v = _layernorm(jax.nn.gelu(v), ln_g, ln_b)
    vc = v.reshape(B, S // CHUNK, CHUNK, SGU_HEADS, SGU_HEAD_DIM)
    mask = jnp.tril(jnp.ones((CHUNK, CHUNK), dtype=bool))
    w = jnp.where(mask[None], sgu_w, jnp.zeros((), sgu_w.dtype))
    z = jnp.einsum('hts,bcshd->bcthd', w, vc) + jnp.transpose(sgu_b)[None, None, :, :, None]
    return u * z.reshape(B, S, D_SGU)


def _causal_dwconv(h, w, b):
    S = h.shape[1]
    hp = jnp.pad(h, ((0, 0), (CONV_WIDTH - 1, 0), (0, 0)))
    y = b
    for k in range(CONV_WIDTH):
        y = y + hp[:, k:k + S] * w[k]
    return y


def setup_inputs(seed: int = 0) -> dict:
    key = jax.random.key(seed)
    ks = jax.random.split(key, 24)
    nrm = lambda k, shp: jax.random.normal(k, shp, dtype=jnp.float32)
    L, D = DEPTH, D_MODEL
    ada_b = jnp.concatenate([
        0.02 * nrm(ks[3], (L, 2 * D)),
        1.0 + 0.02 * nrm(ks[4], (L, D)),
        0.02 * nrm(ks[5], (L, 2 * D)),
        1.0 + 0.02 * nrm(ks[6], (L, D)),
    ], axis=-1)
    return {
        "x": nrm(ks[0], (BATCH, SEQ, D)),
        "c": nrm(ks[1], (BATCH, D)),
        "ada_w": 0.1 * D ** -0.5 * nrm(ks[2], (L, D, N_MOD * D)),
        "ada_b": ada_b,
        "w_in": D ** -0.5 * nrm(ks[7], (L, D, D_IN)),
        "pool_w": POOL_GROUP_DIM ** -0.5 * nrm(ks[8], (L, N_POOL_GROUPS, POOL_GROUP_DIM, POOL_GROUP_DIM)),
        "pool_scale": 1.0 + 0.02 * nrm(ks[9], (L, D_POOL)),
        "sgu_ln_g": 1.0 + 0.02 * nrm(ks[10], (L, D_SGU)),
        "sgu_ln_b": 0.02 * nrm(ks[11], (L, D_SGU)),
        "sgu_w": CHUNK ** -0.5 * nrm(ks[12], (L, SGU_HEADS, CHUNK, CHUNK)),
        "sgu_b": 1.0 + 0.02 * nrm(ks[13], (L, SGU_HEADS, CHUNK)),
        "w_out": DEEPNORM_BETA * D_MIX ** -0.5 * nrm(ks[14], (L, D_MIX, D)),
        "ln1_g": 1.0 + 0.02 * nrm(ks[15], (L, D)),
        "ln1_b": 0.02 * nrm(ks[16], (L, D)),
        "w_up": D ** -0.5 * nrm(ks[17], (L, D, 2 * D_FF)),
        "conv_w": 0.5 * nrm(ks[18], (L, CONV_WIDTH, D_FF)),
        "conv_b": 0.02 * nrm(ks[19], (L, D_FF)),
        "w_down": DEEPNORM_BETA * D_FF ** -0.5 * nrm(ks[20], (L, D_FF, D)),
        "ln2_g": 1.0 + 0.02 * nrm(ks[21], (L, D)),
        "ln2_b": 0.02 * nrm(ks[22], (L, D)),
    }


def reference(x, c, ada_w, ada_b, w_in, pool_w, pool_scale, sgu_ln_g, sgu_ln_b, sgu_w, sgu_b,
              w_out, ln1_g, ln1_b, w_up, conv_w, conv_b, w_down, ln2_g, ln2_b):
    c_act = jax.nn.silu(c)
    for l in range(DEPTH):
        mod = c_act @ ada_w[l] + ada_b[l]
        shift1, scale1, gate1, shift2, scale2, gate2 = jnp.split(mod, N_MOD, axis=-1)

        h = _modulate(x, shift1, scale1)
        proj = jnp.einsum('bsd,de->bse', h, w_in[l])
        a = proj[..., :D_POOL]
        u = proj[..., D_POOL:D_POOL + D_SGU]
        v = proj[..., D_POOL + D_SGU:]
        y_a = _pool_mixer(a, pool_w[l], pool_scale[l])
        y_b = _sgu_mixer(u, v, sgu_ln_g[l], sgu_ln_b[l], sgu_w[l], sgu_b[l])
        mix = jnp.concatenate([y_a, y_b], axis=-1)
        f = jnp.einsum('bse,ed->bsd', mix, w_out[l])
        x = _layernorm(DEEPNORM_ALPHA * x + gate1[:, None, :] * f, ln1_g[l], ln1_b[l])

        h = _modulate(x, shift2, scale2)
        up = jnp.einsum('bsd,df->bsf', h, w_up[l])
        g, val = up[..., :D_FF], up[..., D_FF:]
        g = _causal_dwconv(g, conv_w[l], conv_b[l])
        f = jnp.einsum('bsf,fd->bsd', jax.nn.gelu(g) * val, w_down[l])
        x = _layernorm(DEEPNORM_ALPHA * x + gate2[:, None, :] * f, ln2_g[l], ln2_b[l])
    return x
```

```cpp
#include <hip/hip_runtime.h>
#include <hip/hip_cooperative_groups.h>
#include <cstdio>
#include <cstdint>
namespace cg = cooperative_groups;
namespace pg8 {
#define PG8_LAS __attribute__((address_space(3)))
typedef unsigned short bf16_t;
typedef short bf16x8 __attribute__((ext_vector_type(8)));
typedef float f32x4 __attribute__((ext_vector_type(4)));
typedef unsigned u32x4 __attribute__((ext_vector_type(4)));
constexpr int BM = 256, BK = 64, HALF = 128, HTB = HALF * BK * 2  , STAGE_BYTES = 8 * HTB, NXCD = 8, WGM = 8;

__host__ __device__ __forceinline__ int lds_byte(int r, int c) { const int st = (r >> 4) * 2 + (c >> 5), rr = r & 15, cc = c & 31, ob = rr * 64 + cc * 2; return st * 1024 + (ob ^ (((ob >> 9) & 1) << 5)); }
__host__ __device__ __forceinline__ void stage_rc(int b, int& R, int& C) { const int st = b / 1024, sb = b % 1024, swz = sb ^ (((sb >> 9) & 1) << 5); R = (st >> 1) * 16 + swz / 64; C = (st & 1) * 32 + (swz % 64) / 2; }
__host__ __device__ __forceinline__ int perm32(int rho) { const int n = rho >> 4, i = rho & 15; return 8 * (i >> 2) + 4 * n + (i & 3); }

struct Unit { int pm, pn; };
struct Gemm { const bf16_t* A; const bf16_t* Bt; int M, N, K; int pmb; size_t bbytes; };

struct StaticOrder {
    int nM, nN, nwg, G, c;
    __host__ __device__ __forceinline__ void init(int M, int N, int G_, int c_) { nM = M / BM; nN = N / BM; nwg = nM * nN; G = G_; c = c_; }
    __host__ __device__ __forceinline__ bool next(int i, Unit& u) const {
        const long L = (long)i * G + c; if (L >= nwg) return false;
        int wgid = (int)L; { const int q = nwg / NXCD, r = nwg % NXCD, xcd = wgid % NXCD, off = wgid / NXCD; wgid = (xcd < r ? xcd * (q + 1) : r * (q + 1) + (xcd - r) * q) + off; }
        const int nig = WGM * nN, gid = wgid / nig, fm = gid * WGM, gsz = (nM - fm) < WGM ? (nM - fm) : WGM;
        u.pm = fm + ((wgid % nig) % gsz); u.pn = (wgid % nig) / gsz; return true;
    }
    __device__ __forceinline__ void a_ready(const Unit&) const {}
    __device__ __forceinline__ void done(const Unit&) const {}
};

__device__ __forceinline__ unsigned cvt_pk_bf16(float lo, float hi) { unsigned r; asm volatile("v_cvt_pk_bf16_f32 %0, %1, %2" : "=v"(r) : "v"(lo), "v"(hi)); return r; }
struct PanelStats {
    unsigned* xbuf;
    unsigned* cnt;
    unsigned* tmo;
    int ntn; float eps; int pm_base;
    unsigned code;
    __device__ __forceinline__ bool run(const f32x4 (&v)[2][2][4][2], const Unit& u, int wr, int wc, int fr, int fq, PG8_LAS unsigned char* lds, int wid, int lane) const {
        typedef float f32x2v __attribute__((ext_vector_type(2)));
        PG8_LAS f32x2v* P = (PG8_LAS f32x2v*)lds;
        PG8_LAS f32x2v* S = (PG8_LAS f32x2v*)(lds + 8192);
        PG8_LAS unsigned* flag = (PG8_LAS unsigned*)(lds + 8192 + 2048);
#pragma unroll
        for (int ai = 0; ai < 2; ++ai)
#pragma unroll
            for (int m = 0; m < 4; ++m) {
                float s = 0.f;
#pragma unroll
                for (int bj = 0; bj < 2; ++bj)
#pragma unroll
                    for (int n = 0; n < 2; ++n) { const f32x4 x = v[ai][bj][m][n]; s += (x[0] + x[1]) + (x[2] + x[3]); }
                s += __shfl_xor(s, 16); s += __shfl_xor(s, 32);
                const float mw = s * (1.0f / 64.0f); float q = 0.f;
#pragma unroll
                for (int bj = 0; bj < 2; ++bj)
#pragma unroll
                    for (int n = 0; n < 2; ++n) { const f32x4 d = v[ai][bj][m][n] - mw; q += (d[0] * d[0] + d[1] * d[1]) + (d[2] * d[2] + d[3] * d[3]); }
                q += __shfl_xor(q, 16); q += __shfl_xor(q, 32);
                if (fq == 0) P[(ai * HALF + wr * 64 + m * 16 + fr) * 4 + wc] = (f32x2v){mw, q};
            }
        asm volatile("s_waitcnt lgkmcnt(0)" ::: "memory"); __builtin_amdgcn_s_barrier(); asm volatile("" ::: "memory");
#if defined(BROKEN_EXCHANGE_NO_WAIT)
#warning BROKEN CONTROL BUILD: the row-statistics exchange does not wait; results are wrong by design
        if (blockIdx.x >= 64) { const long long t0_ = clock64(); while (clock64() - t0_ < 60000) __builtin_amdgcn_s_sleep(8); }
#endif
        const int row = wid * 32 + (lane & 31);
        if (lane < 32) {
            const f32x2v a = P[row * 4 + 0], b = P[row * 4 + 1], c = P[row * 4 + 2], d = P[row * 4 + 3];
            const float mt = (a.x + b.x + c.x + d.x) * 0.25f;
            const float da = a.x - mt, db = b.x - mt, dc = c.x - mt, dd = d.x - mt;
            const float m2 = (a.y + b.y) + (c.y + d.y) + 64.0f * ((da * da + db * db) + (dc * dc + dd * dd));
            unsigned long long* slot = (unsigned long long*)xbuf + ((size_t)((pm_base + u.pm) * BM + row) * 4 + u.pn);
            __hip_atomic_store(slot, ((unsigned long long)__float_as_uint(m2) << 32) | __float_as_uint(mt), __ATOMIC_RELAXED, __HIP_MEMORY_SCOPE_AGENT);
        }
        asm volatile("s_waitcnt vmcnt(0)" ::: "memory");
        if (lane == 0) __hip_atomic_fetch_add(cnt + 64 * (pm_base + u.pm), 1u, __ATOMIC_RELAXED, __HIP_MEMORY_SCOPE_AGENT);
        if (wid == 0) {
            bool dead = false; const unsigned long long t0 = __builtin_amdgcn_s_memrealtime(); const unsigned want = 8u * (unsigned)ntn;
            for (;;) {
#if defined(BROKEN_EXCHANGE_NO_WAIT)
                break;
#endif
                if ((unsigned)__builtin_amdgcn_readfirstlane(__hip_atomic_load(cnt + 64 * (pm_base + u.pm), __ATOMIC_RELAXED, __HIP_MEMORY_SCOPE_AGENT)) >= want) break;
                if (__builtin_amdgcn_s_memrealtime() - t0 > 2000000ull) {
                    if (lane == 0) { unsigned expect = 0u; __hip_atomic_compare_exchange_strong(tmo + 1, &expect, code | (unsigned)(u.pm & 0xff), __ATOMIC_RELAXED, __ATOMIC_RELAXED, __HIP_MEMORY_SCOPE_AGENT);
                                     __hip_atomic_store(tmo, 1u, __ATOMIC_RELAXED, __HIP_MEMORY_SCOPE_AGENT); }
                    dead = true; break; }
                __builtin_amdgcn_s_sleep(2);
            }
            __builtin_amdgcn_fence(__ATOMIC_ACQUIRE, "agent");
            if (lane == 0) flag[0] = dead ? 1u : 0u;
        }
        asm volatile("s_waitcnt vmcnt(0) lgkmcnt(0)" ::: "memory"); __builtin_amdgcn_s_barrier(); asm volatile("" ::: "memory");
        const bool bad = flag[0] != 0u;
        if (lane < 32) {
            const unsigned long long* slot = (const unsigned long long*)xbuf + (size_t)((pm_base + u.pm) * BM + row) * 4; float mt[4], m2[4]; float ms = 0.f;
#pragma unroll
            for (int t = 0; t < 4; ++t) { if (t < ntn) { const unsigned long long w = __hip_atomic_load(slot + t, __ATOMIC_RELAXED, __HIP_MEMORY_SCOPE_AGENT); mt[t] = __uint_as_float((unsigned)w); m2[t] = __uint_as_float((unsigned)(w >> 32)); } else { mt[t] = 0.f; m2[t] = 0.f; } ms += mt[t]; }
            const float mean = ms / (float)ntn; float q = 0.f;
#pragma unroll
            for (int t = 0; t < 4; ++t) if (t < ntn) { const float dm = mt[t] - mean; q += m2[t] + 256.0f * dm * dm; }
            S[row] = (f32x2v){mean, 1.0f / sqrtf(q / (256.0f * (float)ntn) + eps)};
        }
        asm volatile("s_waitcnt lgkmcnt(0)" ::: "memory"); __builtin_amdgcn_s_barrier(); asm volatile("" ::: "memory");
        return bad;
    }
};
typedef unsigned u32x2v __attribute__((ext_vector_type(2)));
__device__ __forceinline__ float gelu_t(float x) {
    const float u = x * (0.7978845608f + 0.0356774081f * x * x);
    const float e = __builtin_amdgcn_exp2f(-2.885390082f * u);
    return x * __builtin_amdgcn_rcpf(1.0f + e);
}
typedef float f32x2 __attribute__((ext_vector_type(2)));
__device__ __forceinline__ f32x2 gelu2(f32x2 x) {
    const f32x2 t = x * x;
    const f32x2 pp = t * (-0.1029432394f) + (-2.3022081981f);
    const f32x2 sx = x * pp;
    f32x2 e; e.x = __builtin_amdgcn_exp2f(sx.x); e.y = __builtin_amdgcn_exp2f(sx.y);
    const f32x2 d = e + 1.0f;
    f32x2 r; r.x = __builtin_amdgcn_rcpf(d.x); r.y = __builtin_amdgcn_rcpf(d.y);
    return x * r;
}
__device__ __forceinline__ f32x4 gelu4(f32x4 v) { const f32x2 a = gelu2((f32x2){v[0], v[1]}), b = gelu2((f32x2){v[2], v[3]}); return (f32x4){a.x, a.y, b.x, b.y}; }
__device__ __forceinline__ float dpp_ror1(float v) { return __int_as_float(__builtin_amdgcn_update_dpp(0, __float_as_int(v), 0x121, 0xf, 0xf, false)); }
__device__ __forceinline__ float dpp_ror2(float v) { return __int_as_float(__builtin_amdgcn_update_dpp(0, __float_as_int(v), 0x122, 0xf, 0xf, false)); }

__device__ __forceinline__ void row_stat(const float* stats  , int row, float& mu, float& rs) {
    const f32x4 a = *(const f32x4*)(stats + (size_t)row * 8), b = *(const f32x4*)(stats + (size_t)row * 8 + 4);
    const float mean = ((a[0] + a[2]) + (b[0] + b[2])) * 0.25f;
    const float d0 = a[0] - mean, d1 = a[2] - mean, d2 = b[0] - mean, d3 = b[2] - mean;
    const float m2 = ((a[1] + a[3]) + (b[1] + b[3])) + 256.0f * ((d0 * d0 + d1 * d1) + (d2 * d2 + d3 * d3));
    mu = mean; rs = 1.0f / sqrtf(m2 * (1.0f / 1024.0f) + 1e-5f);
}

typedef float f32x2s __attribute__((ext_vector_type(2)));
#define PG8_RSTAB(ldsx) ((PG8_LAS f32x2s*)((ldsx) + 8192))
__device__ __forceinline__ void rowstat_issue(const float* stats, int pm, int tid, f32x4& a, f32x4& b) {
    if (tid < 256) { const float* q = stats + (size_t)(pm * BM + tid) * 8; a = *(const f32x4*)q; b = *(const f32x4*)(q + 4); }
}
__device__ __forceinline__ void rowstat_finish(PG8_LAS unsigned char* ldsx, int tid, const f32x4& a, const f32x4& b) {
    if (tid < 256) {
        const float mean = ((a[0] + a[2]) + (b[0] + b[2])) * 0.25f;
        const float d0 = a[0] - mean, d1 = a[2] - mean, d2 = b[0] - mean, d3 = b[2] - mean;
        const float m2 = ((a[1] + a[3]) + (b[1] + b[3])) + 256.0f * ((d0 * d0 + d1 * d1) + (d2 * d2 + d3 * d3));
        PG8_RSTAB(ldsx)[tid] = (f32x2s){mean, 1.0f / sqrtf(m2 * (1.0f / 1024.0f) + 1e-5f)};
    }
}

#define PG8_SIDE(ldsx, par) ((ldsx) + 8192 + (par) * 6144)
__device__ __forceinline__ void side_rowstats(const float* stats, int pm, PG8_LAS unsigned char* side, int tid, bool nostat) {
    if (tid < 256) {
        f32x2s r = (f32x2s){0.f, 1.f};
        if (!nostat) { const float* q = stats + (size_t)(pm * BM + tid) * 8; const f32x4 a = *(const f32x4*)q, b = *(const f32x4*)(q + 4);
            const float mean = ((a[0] + a[2]) + (b[0] + b[2])) * 0.25f;
            const float d0 = a[0] - mean, d1 = a[2] - mean, d2 = b[0] - mean, d3 = b[2] - mean;
            const float m2 = ((a[1] + a[3]) + (b[1] + b[3])) + 256.0f * ((d0 * d0 + d1 * d1) + (d2 * d2 + d3 * d3));
            r = (f32x2s){mean, 1.0f / sqrtf(m2 * (1.0f / 1024.0f) + 1e-5f)}; }
        ((PG8_LAS f32x2s*)side)[tid] = r;
    }
}

struct EpiProj {
    static constexpr bool PERM = true, AFTER_DRAIN = false;
    bf16_t* O; int ldc; const float* stats; const float* U; const float* V; int nostat;
    __device__ __forceinline__ void prefetch(const Unit& u, int par, PG8_LAS unsigned char* ldsx, int tid) const {
        PG8_LAS unsigned char* side = PG8_SIDE(ldsx, par); const int b = u.pm >> 6;
        side_rowstats(stats, u.pm, side, tid, nostat != 0);
        if (tid >= 256) { const int c = tid - 256; PG8_LAS float* vv = (PG8_LAS float*)(side + 2048);
            vv[c] = U[(size_t)b * ldc + u.pn * BM + c]; vv[256 + c] = V[(size_t)b * ldc + u.pn * BM + c]; }
    }
    __device__ __forceinline__ void operator()(f32x4 (&acc)[2][2][4][2], const Unit& u, int wr, int wc, int fr, int fq, PG8_LAS unsigned char* ldsx, int par) const {
        const int row0 = u.pm * BM + wr * 64 + fr, col0 = u.pn * BM + wc * 32 + 8 * fq;
        const bool act = u.pn >= 2;
        const PG8_LAS unsigned char* side = PG8_SIDE(ldsx, par);
        const PG8_LAS f32x2s* RS = (const PG8_LAS f32x2s*)side; const PG8_LAS float* UU = (const PG8_LAS float*)(side + 2048); const PG8_LAS float* VV = UU + 256;
#pragma unroll
        for (int bj = 0; bj < 2; ++bj) {
            const int cl = bj * HALF + wc * 32 + 8 * fq;
            const f32x4 u0 = *(const PG8_LAS f32x4*)(UU + cl), u1 = *(const PG8_LAS f32x4*)(UU + cl + 4), q0 = *(const PG8_LAS f32x4*)(VV + cl), q1 = *(const PG8_LAS f32x4*)(VV + cl + 4);
#pragma unroll
            for (int ai = 0; ai < 2; ++ai)
#pragma unroll
                for (int m = 0; m < 4; ++m) {
                    const f32x2s st = RS[ai * HALF + wr * 64 + m * 16 + fr];
                    f32x4 v0 = st.y * (acc[ai][bj][m][0] - st.x * u0) + q0, v1 = st.y * (acc[ai][bj][m][1] - st.x * u1) + q1;
                    if (act) { v0 = gelu4(v0); v1 = gelu4(v1); }
                    u32x4 w; w.x = cvt_pk_bf16(v0[0], v0[1]); w.y = cvt_pk_bf16(v0[2], v0[3]); w.z = cvt_pk_bf16(v1[0], v1[1]); w.w = cvt_pk_bf16(v1[2], v1[3]);
                    *(u32x4*)(O + (size_t)(row0 + ai * HALF + m * 16) * ldc + col0 + bj * HALF) = w; }
        }
    }
};

struct EpiConv {
    static constexpr bool PERM = true, AFTER_DRAIN = false;
    bf16_t* HID; const float* cw; const float* cb; float* headg; float* headv; float* tailg; int FF; const float* stats; const float* U; const float* V;
    __device__ __forceinline__ void prefetch(const Unit& u, int par, PG8_LAS unsigned char* ldsx, int tid) const {
        PG8_LAS unsigned char* side = PG8_SIDE(ldsx, par); const int b = u.pm >> 6;
        side_rowstats(stats, u.pm, side, tid, false);
        if (tid >= 256) { const int c = tid - 256; PG8_LAS float* vv = (PG8_LAS float*)(side + 2048);
            vv[c] = U[(size_t)b * 2 * FF + u.pn * BM + c]; vv[256 + c] = V[(size_t)b * 2 * FF + u.pn * BM + c]; }
        { const int arr = tid >> 7, f = tid & 127; PG8_LAS float* cc = (PG8_LAS float*)(side + 4096);
          cc[tid] = arr < 3 ? cw[(size_t)arr * FF + u.pn * 128 + f] : cb[u.pn * 128 + f]; }
    }
    __device__ __forceinline__ void operator()(f32x4 (&acc)[2][2][4][2], const Unit& u, int wr, int wc, int fr, int fq, PG8_LAS unsigned char* ldsx, int par) const {
        PG8_LAS float* HALO = (PG8_LAS float*)ldsx;
        const int fl = wc * 32 + 8 * fq, f0 = u.pn * 128 + fl;
        const PG8_LAS unsigned char* side = PG8_SIDE(ldsx, par);
        f32x4 w0[2], w1[2], w2[2], bb[2];
        {
            const PG8_LAS f32x2s* RS = (const PG8_LAS f32x2s*)side; const PG8_LAS float* UU = (const PG8_LAS float*)(side + 2048); const PG8_LAS float* VV = UU + 256; const PG8_LAS float* CC = (const PG8_LAS float*)(side + 4096);
#pragma unroll
            for (int n = 0; n < 2; ++n) { w0[n] = *(const PG8_LAS f32x4*)(CC + fl + 4 * n); w1[n] = *(const PG8_LAS f32x4*)(CC + 128 + fl + 4 * n); w2[n] = *(const PG8_LAS f32x4*)(CC + 256 + fl + 4 * n); bb[n] = *(const PG8_LAS f32x4*)(CC + 384 + fl + 4 * n); }
#pragma unroll
            for (int bj = 0; bj < 2; ++bj) {
                const int cl = bj * HALF + fl;
                const f32x4 u0 = *(const PG8_LAS f32x4*)(UU + cl), u1 = *(const PG8_LAS f32x4*)(UU + cl + 4), q0 = *(const PG8_LAS f32x4*)(VV + cl), q1 = *(const PG8_LAS f32x4*)(VV + cl + 4);
#pragma unroll
                for (int ai = 0; ai < 2; ++ai)
#pragma unroll
                    for (int m = 0; m < 4; ++m) { const f32x2s st = RS[ai * HALF + wr * 64 + m * 16 + fr]; acc[ai][bj][m][0] = st.y * (acc[ai][bj][m][0] - st.x * u0) + q0; acc[ai][bj][m][1] = st.y * (acc[ai][bj][m][1] - st.x * u1) + q1; }
#pragma unroll
                for (int ai = 0; ai < 2; ++ai) asm volatile("" : "+v"(acc[ai][bj][0][0]), "+v"(acc[ai][bj][0][1]), "+v"(acc[ai][bj][1][0]), "+v"(acc[ai][bj][1][1]), "+v"(acc[ai][bj][2][0]), "+v"(acc[ai][bj][2][1]), "+v"(acc[ai][bj][3][0]), "+v"(acc[ai][bj][3][1]));
            }
        }
        if (fr >= 14) {
#pragma unroll
            for (int ai = 0; ai < 2; ++ai)
#pragma unroll
                for (int n = 0; n < 2; ++n) *(PG8_LAS f32x4*)(HALO + ((2 * ai + wr) * 2 + (fr - 14)) * 128 + fl + 4 * n) = acc[ai][0][3][n];
        }
        asm volatile("s_waitcnt lgkmcnt(0)" ::: "memory"); __builtin_amdgcn_s_barrier(); asm volatile("" ::: "memory");
#pragma unroll
        for (int ai = 0; ai < 2; ++ai) {
            const int q = 2 * ai + wr;
            f32x4 prev[2] = {(f32x4){0.f, 0.f, 0.f, 0.f}, (f32x4){0.f, 0.f, 0.f, 0.f}};
            if (q > 0 && fr >= 14) {
#pragma unroll
                for (int n = 0; n < 2; ++n) prev[n] = *(const PG8_LAS f32x4*)(HALO + ((q - 1) * 2 + (fr - 14)) * 128 + fl + 4 * n);
            }
            f32x4 r1p[2], r2p[2];
#pragma unroll
            for (int n = 0; n < 2; ++n)
#pragma unroll
                for (int j = 0; j < 4; ++j) { r1p[n][j] = dpp_ror1(prev[n][j]); r2p[n][j] = dpp_ror2(prev[n][j]); }
#pragma unroll
            for (int m = 0; m < 4; ++m) {
                const int rl = ai * HALF + wr * 64 + m * 16 + fr;
                f32x4 hv[2];
#pragma unroll
                for (int n = 0; n < 2; ++n) {
                    const f32x4 cur = acc[ai][0][m][n], val = acc[ai][1][m][n];
                    f32x4 r1, r2;
#pragma unroll
                    for (int j = 0; j < 4; ++j) { r1[j] = dpp_ror1(cur[j]); r2[j] = dpp_ror2(cur[j]); }
                    const f32x4 g1 = fr >= 1 ? r1 : r1p[n], g2 = fr >= 2 ? r2 : r2p[n];
                    const f32x4 pre = bb[n] + w0[n] * g2 + w1[n] * g1 + w2[n] * cur;
                    hv[n] = gelu4(pre) * val;
                    r1p[n] = r1; r2p[n] = r2;
                }
                u32x4 w; w.x = cvt_pk_bf16(hv[0][0], hv[0][1]); w.y = cvt_pk_bf16(hv[0][2], hv[0][3]); w.z = cvt_pk_bf16(hv[1][0], hv[1][1]); w.w = cvt_pk_bf16(hv[1][2], hv[1][3]);
                *(u32x4*)(HID + (size_t)(u.pm * BM + rl) * FF + f0) = w;
                if (q == 0 && m == 0 && fr < 2) {
#pragma unroll
                    for (int n = 0; n < 2; ++n) { *(f32x4*)(headg + (size_t)(u.pm * 2 + fr) * FF + f0 + 4 * n) = acc[0][0][0][n]; *(f32x4*)(headv + (size_t)(u.pm * 2 + fr) * FF + f0 + 4 * n) = acc[0][1][0][n]; }
                }
                if (q == 3 && m == 3 && fr >= 14) {
#pragma unroll
                    for (int n = 0; n < 2; ++n) *(f32x4*)(tailg + (size_t)(u.pm * 2 + (fr - 14)) * FF + f0 + 4 * n) = acc[1][0][3][n];
                }
            }
        }
    }
};

template <bool BASE_F32> struct EpiY {
    static constexpr bool PERM = true, AFTER_DRAIN = false;
    const float* base; bf16_t* Y; int ldc; const float* modl; int goff; const float* pg; const float* pb; const float* sprev; float* snew;
    __device__ __forceinline__ void prefetch(const Unit& u, int par, PG8_LAS unsigned char* ldsx, int tid) const {
        PG8_LAS unsigned char* side = PG8_SIDE(ldsx, par); const int b = u.pm >> 6;
        if (!BASE_F32) side_rowstats(sprev, u.pm, side, tid, false);
        if (tid >= 256) { const int c = tid - 256, cg = u.pn * BM + c; PG8_LAS float* vv = (PG8_LAS float*)(side + 2048);
            vv[c] = modl[(size_t)b * 6144 + goff + cg];
            if (!BASE_F32) { vv[256 + c] = pg[cg]; vv[512 + c] = pb[cg]; } }
    }
    __device__ __forceinline__ void operator()(f32x4 (&acc)[2][2][4][2], const Unit& u, int wr, int wc, int fr, int fq, PG8_LAS unsigned char* ldsx, int par) const {
        typedef float f32x2v __attribute__((ext_vector_type(2)));
        const int row0 = u.pm * BM + wr * 64 + fr, col0 = u.pn * BM + wc * 32 + 8 * fq;
        const int lane = fq * 16 + fr, wid = wr * 4 + wc;
        const float ALPHA = 1.6817928305074290f;
        const PG8_LAS unsigned char* side = PG8_SIDE(ldsx, par);
        const PG8_LAS f32x2s* RS = (const PG8_LAS f32x2s*)side; const PG8_LAS float* GT = (const PG8_LAS float*)(side + 2048);
        f32x4 gt0, gt1, g0, g1, b0, b1; u32x4 yv[4];
#define EPIY_LOADS(bj_) do { const int cl_ = (bj_) * HALF + wc * 32 + 8 * fq; \
            gt0 = *(const PG8_LAS f32x4*)(GT + cl_); gt1 = *(const PG8_LAS f32x4*)(GT + cl_ + 4); g0 = gt0; g1 = gt0; b0 = gt0; b1 = gt0; \
            if (!BASE_F32) { g0 = *(const PG8_LAS f32x4*)(GT + 256 + cl_); g1 = *(const PG8_LAS f32x4*)(GT + 256 + cl_ + 4); b0 = *(const PG8_LAS f32x4*)(GT + 512 + cl_); b1 = *(const PG8_LAS f32x4*)(GT + 512 + cl_ + 4); } } while (0)
#define EPIY_YLOADS(bj_, ai_) do { _Pragma("unroll") for (int m = 0; m < 4; ++m) yv[m] = *(const u32x4*)(Y + (size_t)(row0 + (ai_) * HALF + m * 16) * ldc + col0 + (bj_) * HALF); } while (0)
        EPIY_LOADS(0);
#pragma unroll
        for (int bj = 0; bj < 2; ++bj) {
            const int c = col0 + bj * HALF;
            if (bj == 1) EPIY_LOADS(1);
            if (BASE_F32) {
#pragma unroll
                for (int ai = 0; ai < 2; ++ai) {
                    f32x4 xa[4], xb[4];
#pragma unroll
                    for (int m = 0; m < 4; ++m) { const size_t off = (size_t)(row0 + ai * HALF + m * 16) * ldc + c; xa[m] = *(const f32x4*)(base + off); xb[m] = *(const f32x4*)(base + off + 4); }
#pragma unroll
                    for (int m = 0; m < 4; ++m) { acc[ai][bj][m][0] = ALPHA * xa[m] + gt0 * acc[ai][bj][m][0]; acc[ai][bj][m][1] = ALPHA * xb[m] + gt1 * acc[ai][bj][m][1]; }
                    asm volatile("" : "+v"(acc[ai][bj][0][0]), "+v"(acc[ai][bj][0][1]), "+v"(acc[ai][bj][1][0]), "+v"(acc[ai][bj][1][1]), "+v"(acc[ai][bj][2][0]), "+v"(acc[ai][bj][2][1]), "+v"(acc[ai][bj][3][0]), "+v"(acc[ai][bj][3][1]));
                    asm volatile("" ::: "memory");
                }
            } else {
#pragma unroll
                for (int ai = 0; ai < 2; ++ai) {
                    EPIY_YLOADS(bj, ai);
#pragma unroll
                    for (int m = 0; m < 4; ++m) { const u32x4 q = yv[m]; const f32x2s st = RS[ai * HALF + wr * 64 + m * 16 + fr];
                        const f32x4 y0 = (f32x4){__uint_as_float(q.x << 16), __uint_as_float(q.x & 0xffff0000u), __uint_as_float(q.y << 16), __uint_as_float(q.y & 0xffff0000u)};
                        const f32x4 y1 = (f32x4){__uint_as_float(q.z << 16), __uint_as_float(q.z & 0xffff0000u), __uint_as_float(q.w << 16), __uint_as_float(q.w & 0xffff0000u)};
                        const f32x4 x0 = (y0 - st.x) * st.y * g0 + b0, x1 = (y1 - st.x) * st.y * g1 + b1;
                        acc[ai][bj][m][0] = ALPHA * x0 + gt0 * acc[ai][bj][m][0]; acc[ai][bj][m][1] = ALPHA * x1 + gt1 * acc[ai][bj][m][1]; }
                    asm volatile("" : "+v"(acc[ai][bj][0][0]), "+v"(acc[ai][bj][0][1]), "+v"(acc[ai][bj][1][0]), "+v"(acc[ai][bj][1][1]), "+v"(acc[ai][bj][2][0]), "+v"(acc[ai][bj][2][1]), "+v"(acc[ai][bj][3][0]), "+v"(acc[ai][bj][3][1]));
                    asm volatile("" ::: "memory");
                }
            }
        }
#undef EPIY_LOADS
#undef EPIY_YLOADS
        PG8_LAS f32x2v* P = (PG8_LAS f32x2v*)ldsx;
#pragma unroll
        for (int ai = 0; ai < 2; ++ai)
#pragma unroll
            for (int m = 0; m < 4; ++m) {
                float s = 0.f;
#pragma unroll
                for (int bj = 0; bj < 2; ++bj)
#pragma unroll
                    for (int n = 0; n < 2; ++n) { const f32x4 x = acc[ai][bj][m][n]; s += (x[0] + x[1]) + (x[2] + x[3]); }
                s += __shfl_xor(s, 16); s += __shfl_xor(s, 32);
                const float mw = s * (1.0f / 64.0f); float q = 0.f;
#pragma unroll
                for (int bj = 0; bj < 2; ++bj)
#pragma unroll
                    for (int n = 0; n < 2; ++n) { const f32x4 d = acc[ai][bj][m][n] - mw; q += (d[0] * d[0] + d[1] * d[1]) + (d[2] * d[2] + d[3] * d[3]); }
                q += __shfl_xor(q, 16); q += __shfl_xor(q, 32);
                if (fq == 0) P[(ai * HALF + wr * 64 + m * 16 + fr) * 4 + wc] = (f32x2v){mw, q};
            }
        asm volatile("s_waitcnt lgkmcnt(0)" ::: "memory"); __builtin_amdgcn_s_barrier(); asm volatile("" ::: "memory");
        if (lane < 32) {
            const int row = wid * 32 + lane;
            const f32x2v a = P[row * 4 + 0], bq = P[row * 4 + 1], cq = P[row * 4 + 2], dq = P[row * 4 + 3];
            const float mt = ((a.x + bq.x) + (cq.x + dq.x)) * 0.25f;
            const float da = a.x - mt, db = bq.x - mt, dc = cq.x - mt, dd = dq.x - mt;
            const float m2 = ((a.y + bq.y) + (cq.y + dq.y)) + 64.0f * ((da * da + db * db) + (dc * dc + dd * dd));
            *(f32x2v*)(snew + (size_t)(u.pm * BM + row) * 8 + u.pn * 2) = (f32x2v){mt, m2};
        }
#pragma unroll
        for (int ai = 0; ai < 2; ++ai)
#pragma unroll
            for (int m = 0; m < 4; ++m)
#pragma unroll
                for (int bj = 0; bj < 2; ++bj) { const f32x4 v0 = acc[ai][bj][m][0], v1 = acc[ai][bj][m][1];
                    u32x4 w; w.x = cvt_pk_bf16(v0[0], v0[1]); w.y = cvt_pk_bf16(v0[2], v0[3]); w.z = cvt_pk_bf16(v1[0], v1[1]); w.w = cvt_pk_bf16(v1[2], v1[3]);
                    *(u32x4*)(Y + (size_t)(row0 + ai * HALF + m * 16) * ldc + col0 + bj * HALF) = w; }
    }
};

struct EpiNull {
    static constexpr bool PERM = true, AFTER_DRAIN = false;
    float* dummy;
    __device__ __forceinline__ void prefetch(const Unit&, int, PG8_LAS unsigned char*, int) const {}
    __device__ __forceinline__ void operator()(f32x4 (&acc)[2][2][4][2], const Unit& u, int wr, int wc, int fr, int fq, PG8_LAS unsigned char*, int) const {
        f32x4 s = (f32x4){0.f, 0.f, 0.f, 0.f};
#pragma unroll
        for (int ai = 0; ai < 2; ++ai)
#pragma unroll
            for (int bj = 0; bj < 2; ++bj)
#pragma unroll
                for (int m = 0; m < 4; ++m)
#pragma unroll
                    for (int n = 0; n < 2; ++n) s += acc[ai][bj][m][n];
        const float t = (s[0] + s[1]) + (s[2] + s[3]);
        if (t == 1.2345e33f) dummy[(wr * 4 + wc) * 64 + fq * 16 + fr] = t;
    }
};
template <class Epi, class Sched, bool ALIGN_EPI = false, bool SP2 = false>
__device__ __forceinline__ void gemm_phase(PG8_LAS unsigned char* lds, const Gemm g, const Sched& S, const Epi& E) {
    int tid_l = threadIdx.x; asm volatile("" : "+v"(tid_l));
    const int tid = tid_l, wid = __builtin_amdgcn_readfirstlane(tid >> 6), lane = tid & 63, wr = wid >> 2, wc = wid & 3, fr = lane & 15, fq = lane >> 4;
    const int K = g.K, nt = K / BK;
    unsigned voffA[2], voffB[2];
#pragma unroll
    for (int i = 0; i < 2; ++i) { int R, C; stage_rc(tid * 16 + i * 8192, R, C); const int Rb = Epi::PERM ? ((R & ~31) + perm32(R & 31)) : R;
        voffA[i] = (unsigned)(R * K + C) * 2u; voffB[i] = (unsigned)(Rb * K + C) * 2u; }
    const size_t kstep = (size_t)(BK * 2);
    const size_t hstep = (size_t)HALF * K * 2;
    const size_t tstep = 2 * hstep;
    const unsigned ldsw = (unsigned)wid * 1024u;
    const int aoff = lds_byte(wr * 64 + fr, fq * 8), boff = lds_byte(wc * 32 + fr, fq * 8);
#define PG8_SA(b, h) (((b) * 2 + (h)) * HTB)
#define PG8_SB(b, h) ((4 + (b) * 2 + (h)) * HTB)
#define PG8_STAGE(bufoff, gbase, voff) do { _Pragma("unroll") for (int _i = 0; _i < 2; ++_i) \
        __builtin_amdgcn_global_load_lds((const unsigned*)((const char*)(gbase) + (voff)[_i]), (PG8_LAS unsigned*)(lds + (bufoff) + ldsw + _i * 8192), 16, 0, 0); } while (0)
#define PG8_LDA(dst, b, h) do { _Pragma("unroll") for (int m = 0; m < 4; ++m) _Pragma("unroll") for (int k = 0; k < 2; ++k) dst[m][k] = *(const PG8_LAS bf16x8*)(lds + PG8_SA(b, h) + aoff + m * 2048 + k * 1024); } while (0)
#define PG8_LDB(dst, b, h) do { _Pragma("unroll") for (int n = 0; n < 2; ++n) _Pragma("unroll") for (int k = 0; k < 2; ++k) dst[n][k] = *(const PG8_LAS bf16x8*)(lds + PG8_SB(b, h) + boff + n * 2048 + k * 1024); } while (0)
#define PG8_MMA(ai, bj, At, Bt) do { __builtin_amdgcn_s_setprio(1); _Pragma("unroll") for (int m = 0; m < 4; ++m) _Pragma("unroll") for (int n = 0; n < 2; ++n) _Pragma("unroll") for (int k = 0; k < 2; ++k) \
        acc[ai][bj][m][n] = __builtin_amdgcn_mfma_f32_16x16x32_bf16(Bt[n][k], At[m][k], acc[ai][bj][m][n], 0, 0, 0); __builtin_amdgcn_s_setprio(0); } while (0)
#define PG8_WAIT_V(n) asm volatile("s_waitcnt vmcnt(" #n ")" ::: "memory")
#define PG8_WAIT_L(n) asm volatile("s_waitcnt lgkmcnt(" #n ")" ::: "memory")
#define PG8_BAR __builtin_amdgcn_s_barrier()
#define PG8_SCHED __builtin_amdgcn_sched_barrier(0)
    Unit cur, nxt; int ui = 0;
    if (!S.next(0, cur)) return;
    f32x4 acc[2][2][4][2];
#pragma unroll
    for (int a = 0; a < 2; ++a)
#pragma unroll
        for (int b = 0; b < 2; ++b)
#pragma unroll
            for (int m = 0; m < 4; ++m)
#pragma unroll
                for (int n = 0; n < 2; ++n) acc[a][b][m][n] = (f32x4){0.f, 0.f, 0.f, 0.f};
    bf16x8 At[4][2], B0[2][2], B1[2][2];
    const char* cA = (const char*)g.A + (size_t)cur.pm * tstep; const char* cB = (const char*)g.Bt + (size_t)cur.pn * tstep + (g.pmb ? (size_t)(cur.pm / g.pmb) * g.bbytes : (size_t)0);
    S.a_ready(cur);
    E.prefetch(cur, 0, lds + STAGE_BYTES + 1024, tid);
    if constexpr (SP2) {
        PG8_STAGE(PG8_SB(0, 0), cB, voffB); PG8_STAGE(PG8_SB(0, 1), cB + hstep, voffB); PG8_STAGE(PG8_SA(0, 0), cA, voffA); PG8_STAGE(PG8_SA(0, 1), cA + hstep, voffA);
        if (wr == 1) PG8_BAR;
        PG8_WAIT_V(2); PG8_BAR;
        PG8_STAGE(PG8_SB(1, 0), cB + kstep, voffB); PG8_STAGE(PG8_SA(1, 0), cA + kstep, voffA); PG8_STAGE(PG8_SB(1, 1), cB + hstep + kstep, voffB);
        PG8_WAIT_V(6); PG8_BAR;
    } else {
        PG8_STAGE(PG8_SB(0, 0), cB, voffB); PG8_STAGE(PG8_SA(0, 0), cA, voffA); PG8_STAGE(PG8_SB(0, 1), cB + hstep, voffB); PG8_STAGE(PG8_SA(0, 1), cA + hstep, voffA);
        if (wr == 1) PG8_BAR;
        PG8_WAIT_V(4); PG8_BAR;
        PG8_STAGE(PG8_SB(1, 0), cB + kstep, voffB); PG8_STAGE(PG8_SA(1, 0), cA + kstep, voffA); PG8_STAGE(PG8_SB(1, 1), cB + hstep + kstep, voffB);
        PG8_WAIT_V(6); PG8_BAR;
    }
    for (;;) {
        const bool has_next = S.next(ui + 1, nxt);
        const char* nA = has_next ? (const char*)g.A + (size_t)nxt.pm * tstep : cA; const char* nB = has_next ? (const char*)g.Bt + (size_t)nxt.pn * tstep + (g.pmb ? (size_t)(nxt.pm / g.pmb) * g.bbytes : (size_t)0) : cB;
        for (int t = 0; t < nt; t += 2) {
            const bool last = (t == nt - 2);
            const char* a1 = cA + (size_t)(t + 1) * kstep;
            const char* a2 = last ? nA : cA + (size_t)(t + 2) * kstep; const char* b2 = last ? nB : cB + (size_t)(t + 2) * kstep;
            const char* a3 = a2 + kstep; const char* b3 = b2 + kstep;
            if (last && has_next) S.a_ready(nxt);
            if constexpr (SP2) {
            PG8_LDB(B0, 0, 0); PG8_LDB(B1, 0, 1); PG8_SCHED; PG8_LDA(At, 0, 0); PG8_STAGE(PG8_SA(1, 1), a1 + hstep, voffA);
            PG8_WAIT_V(8); PG8_WAIT_L(0); PG8_BAR; PG8_MMA(0, 0, At, B0); PG8_MMA(0, 1, At, B1); PG8_BAR; PG8_SCHED;
            PG8_LDA(At, 0, 1); PG8_STAGE(PG8_SB(0, 0), b2, voffB); PG8_STAGE(PG8_SB(0, 1), b2 + hstep, voffB); PG8_STAGE(PG8_SA(0, 0), a2, voffA);
            PG8_WAIT_V(8); PG8_WAIT_L(0); PG8_BAR; PG8_MMA(1, 0, At, B0); PG8_MMA(1, 1, At, B1); PG8_BAR; PG8_SCHED;
            PG8_LDB(B0, 1, 0); PG8_LDB(B1, 1, 1); PG8_SCHED; PG8_LDA(At, 1, 0); PG8_STAGE(PG8_SA(0, 1), a2 + hstep, voffA);
            PG8_WAIT_V(8); PG8_WAIT_L(0); PG8_BAR; PG8_MMA(0, 0, At, B0); PG8_MMA(0, 1, At, B1); PG8_BAR; PG8_SCHED;
            PG8_LDA(At, 1, 1); PG8_STAGE(PG8_SB(1, 0), b3, voffB); PG8_STAGE(PG8_SB(1, 1), b3 + hstep, voffB); PG8_STAGE(PG8_SA(1, 0), a3, voffA);
            PG8_WAIT_V(8); PG8_WAIT_L(0); PG8_BAR; PG8_MMA(1, 0, At, B0); PG8_MMA(1, 1, At, B1); PG8_BAR; PG8_SCHED;
            } else {
            PG8_LDB(B0, 0, 0); PG8_SCHED; PG8_LDA(At, 0, 0); PG8_STAGE(PG8_SA(1, 1), a1 + hstep, voffA);
            PG8_WAIT_L(8); PG8_BAR; PG8_WAIT_L(0); PG8_MMA(0, 0, At, B0); PG8_BAR; PG8_SCHED;
            PG8_LDB(B1, 0, 1); PG8_STAGE(PG8_SB(0, 0), b2, voffB);
            PG8_BAR; PG8_WAIT_L(0); PG8_MMA(0, 1, At, B1); PG8_BAR;
            PG8_LDA(At, 0, 1); PG8_STAGE(PG8_SA(0, 0), a2, voffA);
            PG8_BAR; PG8_WAIT_L(0); PG8_MMA(1, 0, At, B0); PG8_BAR; PG8_SCHED;
            PG8_STAGE(PG8_SB(0, 1), b2 + hstep, voffB);
            PG8_WAIT_V(6); PG8_BAR; PG8_MMA(1, 1, At, B1); PG8_BAR;
            PG8_LDB(B0, 1, 0); PG8_SCHED; PG8_LDA(At, 1, 0); PG8_STAGE(PG8_SA(0, 1), a2 + hstep, voffA);
            PG8_WAIT_L(8); PG8_BAR; PG8_WAIT_L(0); PG8_MMA(0, 0, At, B0); PG8_BAR; PG8_SCHED;
            PG8_LDB(B1, 1, 1); PG8_STAGE(PG8_SB(1, 0), b3, voffB);
            PG8_BAR; PG8_WAIT_L(0); PG8_MMA(0, 1, At, B1); PG8_BAR;
            PG8_LDA(At, 1, 1); PG8_STAGE(PG8_SA(1, 0), a3, voffA);
            PG8_BAR; PG8_WAIT_L(0); PG8_MMA(1, 0, At, B0); PG8_BAR; PG8_SCHED;
            PG8_STAGE(PG8_SB(1, 1), b3 + hstep, voffB);
            PG8_WAIT_V(6); PG8_BAR; PG8_MMA(1, 1, At, B1); PG8_BAR;
            }
        }
        if constexpr (ALIGN_EPI) { if (wr == 0) PG8_BAR; }
        if constexpr (!Epi::AFTER_DRAIN) { E(acc, cur, wr, wc, fr, fq, lds + STAGE_BYTES + 1024, ui & 1);
            if (has_next) E.prefetch(nxt, (ui + 1) & 1, lds + STAGE_BYTES + 1024, tid);
            S.done(cur); }
        if (!has_next) break;
#pragma unroll
        for (int a = 0; a < 2; ++a)
#pragma unroll
            for (int b = 0; b < 2; ++b)
#pragma unroll
                for (int m = 0; m < 4; ++m)
#pragma unroll
                    for (int n = 0; n < 2; ++n) acc[a][b][m][n] = (f32x4){0.f, 0.f, 0.f, 0.f};
        cur = nxt; cA = nA; cB = nB; ++ui;
        if constexpr (ALIGN_EPI) { if (wr == 1) PG8_BAR; }
    }
    PG8_WAIT_V(0);
    if constexpr (!ALIGN_EPI) { if (wr == 0) PG8_BAR; }
    PG8_BAR;
    if constexpr (Epi::AFTER_DRAIN) { E.fused(acc, cur, wr, wc, fr, fq, lds, wid, lane); S.done(cur); }
#undef PG8_SA
#undef PG8_SB
#undef PG8_STAGE
#undef PG8_LDA
#undef PG8_LDB
#undef PG8_MMA
#undef PG8_WAIT_V
#undef PG8_WAIT_L
#undef PG8_BAR
#undef PG8_SCHED
}
}

#define LAS __attribute__((address_space(3)))
typedef unsigned short bf16;
typedef unsigned v4u __attribute__((ext_vector_type(4)));
typedef unsigned v2u __attribute__((ext_vector_type(2)));
typedef float f32x4 __attribute__((ext_vector_type(4)));
typedef float f32x16 __attribute__((ext_vector_type(16)));
typedef short bf16x8 __attribute__((ext_vector_type(8)));
#define LDS_WAIT() asm volatile("s_waitcnt lgkmcnt(0)" ::: "memory")

constexpr int BATCH = 2, SEQ = 16384, D = 1024, DEPTH = 4, M = BATCH * SEQ;
constexpr int DIN = 1536, FF = 2816, NUP = 2 * FF, NMOD = 6 * D;
constexpr float LN_EPS = 1e-5f;
constexpr size_t KiB = 1024, MiB = 1024 * 1024;
constexpr size_t WS_CTL = 0, CTL_BYTES = 512 * KiB;
constexpr size_t WS_MOD = 512 * KiB;
constexpr size_t WS_STATA = 1 * MiB, WS_STATB = 2 * MiB;
constexpr size_t WS_HEADG = 3 * MiB, WS_HEADV = 6 * MiB, WS_TAILG = 9 * MiB;
constexpr size_t WS_POOLWT = 12 * MiB, WS_WTRIL = 12 * MiB + 512 * KiB;
constexpr size_t WS_UIN = 13 * MiB, WS_VIN = WS_UIN + 64 * KiB, WS_UUP = WS_UIN + 128 * KiB, WS_VUP = WS_UUP + 192 * KiB;
constexpr size_t WS_WIN = 14 * MiB, WS_WOUT = 38 * MiB, WS_WUP = 46 * MiB, WS_WDN = 134 * MiB;
constexpr size_t WS_Y = 156 * MiB;
constexpr size_t WS_PROJ = 220 * MiB;
constexpr size_t WS_MIX = 316 * MiB;
constexpr size_t WS_HID = 220 * MiB;
constexpr size_t WS_END = 396 * MiB;
constexpr int CW_TMO = 0, CW_BAR = 4096, CW_RANK = 8192;
static_assert((CW_BAR + 3456) * 4 <= (int)CTL_BYTES && DEPTH * BATCH * (1536 + 5632) * 4 * 2 <= (int)MiB, "ctl / uv");
constexpr int RING_BYTES = 131072, MISC_OFF = 152576, LDS_BYTES = 153600;

struct Params {
    const float *x, *c, *ada_w, *ada_b, *w_in, *pool_w, *pool_scale, *sgu_ln_g, *sgu_ln_b, *sgu_w, *sgu_b, *w_out, *ln1_g, *ln1_b, *w_up, *conv_w, *conv_b, *w_down, *ln2_g, *ln2_b;
    float* out; unsigned char* ws;
};

typedef const __attribute__((address_space(4))) Params* KP;
__device__ __forceinline__ KP kparams() { KP k = (KP)__builtin_amdgcn_kernarg_segment_ptr(); asm volatile("" : "+s"(k)); return k; }
__device__ __forceinline__ float wave_sum(float v) {
#pragma unroll
    for (int o = 1; o < 64; o <<= 1) v += __shfl_xor(v, o);
    return v;
}
__device__ __forceinline__ unsigned f2bf(float f) { unsigned u = __builtin_bit_cast(unsigned, f); return (u + 0x7fffu + ((u >> 16) & 1u)) >> 16; }
__device__ __forceinline__ unsigned pk2(float lo, float hi) { return f2bf(lo) | (f2bf(hi) << 16); }
__device__ __forceinline__ float bflo(unsigned w) { return __uint_as_float(w << 16); }
__device__ __forceinline__ float bfhi(unsigned w) { return __uint_as_float(w & 0xffff0000u); }

__device__ __forceinline__ void p0_transpose_item(const float* W, int ldw, int K, bf16* WT, bf16* WT1, int k0, int n0, int rowdst0, LAS float* scr, int lane, const float* lng, const float* scl0, const float* scl1) {
    float tv[32];
#pragma unroll
    for (int i = 0; i < 32; ++i) { const int kk = 2 * i + (lane >> 5); tv[i] = W[(size_t)(k0 + kk) * ldw + n0 + (lane & 31)]; }
    const int nout = scl0 ? 2 : 1;
    for (int o = 0; o < nout; ++o) {
        const float* scl = o ? scl1 : scl0; bf16* dst = o ? WT1 : WT;
#pragma unroll
        for (int i = 0; i < 32; ++i) { const int kk = 2 * i + (lane >> 5); const float gk = scl ? (lng ? lng[k0 + kk] : 1.0f) * (1.0f + scl[k0 + kk]) : 1.0f; scr[kk * 33 + (lane & 31)] = tv[i] * gk; }
        LDS_WAIT(); asm volatile("" ::: "memory");
        const int c = lane & 7;
#pragma unroll
        for (int j = 0; j < 4; ++j) { const int n = (lane >> 3) + 8 * j; const LAS float* s = scr + (8 * c) * 33 + n;
            v4u ov; ov.x = pk2(s[0 * 33], s[1 * 33]); ov.y = pk2(s[2 * 33], s[3 * 33]); ov.z = pk2(s[4 * 33], s[5 * 33]); ov.w = pk2(s[6 * 33], s[7 * 33]);
            *(v4u*)(dst + (size_t)(rowdst0 + n) * K + k0 + 8 * c) = ov; }
        LDS_WAIT(); asm volatile("" ::: "memory");
    }
}

__device__ __forceinline__ void p0a(LAS unsigned char* lds, KP p) {
    int tid_l = threadIdx.x; asm volatile("" : "+v"(tid_l));
    const int tid = tid_l, lane = tid & 63, wave = tid >> 6, G = gridDim.x;
    unsigned char* ws = p->ws;
    {   unsigned* ctl = (unsigned*)(ws + WS_CTL);
        for (int i = blockIdx.x * 512 + tid; i < (int)(CTL_BYTES / 4); i += G * 512) ctl[i] = 0u; }
    LAS float* sc = (LAS float*)(lds);
    for (int i = tid; i < BATCH * D; i += 512) { const float v = p->c[i]; sc[i] = v / (1.0f + __expf(-v)); }
    __syncthreads();
    {
        LAS float* part = (LAS float*)(lds + 8192);
        float* mod = (float*)(ws + WS_MOD);
        for (int it = blockIdx.x; it < DEPTH * 192; it += G) {
            const int l = it / 192, j0 = (it % 192) * 32, col = lane & 31, dh = lane >> 5;
            const float* w = p->ada_w + (size_t)l * D * NMOD + j0 + col;
            float a0 = 0.f, a1 = 0.f;
#pragma unroll 16
            for (int i = 0; i < 64; ++i) { const int d = 128 * wave + 2 * i + dh; const float wv = w[(size_t)d * NMOD]; a0 += sc[d] * wv; a1 += sc[D + d] * wv; }
            a0 += __shfl_xor(a0, 32); a1 += __shfl_xor(a1, 32);
            if (lane < 32) { part[(wave * 32 + col) * 2] = a0; part[(wave * 32 + col) * 2 + 1] = a1; }
            __syncthreads();
            if (tid < 64) { const int c2 = tid >> 1, bb = tid & 1; float sm = 0.f;
#pragma unroll
                for (int w8 = 0; w8 < 8; ++w8) sm += part[(w8 * 32 + c2) * 2 + bb];
                mod[(l * 2 + bb) * NMOD + j0 + c2] = sm + p->ada_b[l * NMOD + j0 + c2]; }
            __syncthreads();
        }
    }
}
__device__ __forceinline__ void p0b(LAS unsigned char* lds, KP p) {
    int tid_l = threadIdx.x; asm volatile("" : "+v"(tid_l));
    const int tid = tid_l, lane = tid & 63, wave = tid >> 6, G = gridDim.x;
    const int gw = blockIdx.x * 8 + wave, NGW = G * 8;
    unsigned char* ws = p->ws;
    LAS float* scr = (LAS float*)(lds + wave * 8704);
    const float* mod = (const float*)(ws + WS_MOD);
    bf16* WIN = (bf16*)(ws + WS_WIN); bf16* WOUT = (bf16*)(ws + WS_WOUT); bf16* WUP = (bf16*)(ws + WS_WUP); bf16* WDN = (bf16*)(ws + WS_WDN);
    constexpr int I_IN = 16 * 48, I_OUT = 16 * 32, I_UP = 16 * 176, I_DN = 44 * 32, I_LAYER = I_IN + I_OUT + I_UP + I_DN;
    constexpr int I_T = DEPTH * I_LAYER;
    for (int it = gw; it < I_T; it += NGW) {
        const int l = it / I_LAYER; int r = it % I_LAYER; const float* mb = mod + (size_t)(l * 2) * NMOD;
        if (r < I_IN) { const int kb = r / 48, nb = r % 48;
            p0_transpose_item(p->w_in + (size_t)l * D * DIN, DIN, D, WIN + (size_t)(l * 2) * DIN * D, WIN + (size_t)(l * 2 + 1) * DIN * D, 64 * kb, 32 * nb, 32 * nb, scr, lane, l ? p->ln2_g + (l - 1) * D : nullptr, mb + D, mb + NMOD + D); continue; } r -= I_IN;
        if (r < I_OUT) { const int kb = r / 32, nb = r % 32; p0_transpose_item(p->w_out + (size_t)l * D * D, D, D, WOUT + (size_t)l * D * D, nullptr, 64 * kb, 32 * nb, 32 * nb, scr, lane, nullptr, nullptr, nullptr); continue; } r -= I_OUT;
        if (r < I_UP) { const int kb = r / 176, nb = r % 176, n0 = 32 * nb; const int np = n0 < FF ? n0 : n0 - FF; const int rd = (np / 128) * 256 + (n0 < FF ? 0 : 128) + (np % 128);
            p0_transpose_item(p->w_up + (size_t)l * D * NUP, NUP, D, WUP + (size_t)(l * 2) * NUP * D, WUP + (size_t)(l * 2 + 1) * NUP * D, 64 * kb, n0, rd, scr, lane, p->ln1_g + l * D, mb + 4 * D, mb + NMOD + 4 * D); continue; } r -= I_UP;
        { const int kb = r / 32, nb = r % 32; p0_transpose_item(p->w_down + (size_t)l * FF * D, D, FF, WDN + (size_t)l * D * FF, nullptr, 64 * kb, 32 * nb, 32 * nb, scr, lane, nullptr, nullptr, nullptr); }
    }
    {
        bf16* PWF = (bf16*)(ws + WS_POOLWT); bf16* WTF = (bf16*)(ws + WS_WTRIL);
        for (int i = blockIdx.x * 512 + tid; i < DEPTH * 4 * 128 * 128; i += G * 512) {
            const int j = i & 7, ln = (i >> 3) & 63;
            { const int s2 = (i >> 9) & 1, cb = (i >> 10) & 3, db = (i >> 12) & 3, lg = i >> 14;
              const int d = 32 * db + (ln & 31), c = 32 * cb + 16 * s2 + 8 * (j >> 2) + 4 * (ln >> 5) + (j & 3);
              PWF[i] = (bf16)f2bf(p->pool_w[(size_t)lg * 16384 + c * 128 + d]); }
            { const int ks = (i >> 9) & 7, tb2 = (i >> 12) & 3, lh = i >> 14;
              const int t = 32 * tb2 + (ln & 31), s = 16 * ks + 8 * (ln >> 5) + j;
              WTF[i] = (bf16)(s <= t ? f2bf(p->sgu_w[(size_t)lh * 16384 + t * 128 + s]) : 0u); }
        }
    }
    {
        bf16* Y = (bf16*)(ws + WS_Y);
        for (int m0 = gw; m0 < M; m0 += 4 * NGW) {
            f32x4 v[4][4];
#pragma unroll
            for (int r = 0; r < 4; ++r)
#pragma unroll
                for (int j = 0; j < 4; ++j) v[r][j] = *((const f32x4*)(p->x + (size_t)(m0 + r * NGW) * D) + lane + 64 * j);
#pragma unroll
            for (int r = 0; r < 4; ++r) { unsigned long long* o8 = (unsigned long long*)(Y + (size_t)(m0 + r * NGW) * D) + lane;
#pragma unroll
                for (int j = 0; j < 4; ++j) o8[64 * j] = (unsigned long long)pk2(v[r][j].x, v[r][j].y) | ((unsigned long long)pk2(v[r][j].z, v[r][j].w) << 32); }
        }
    }
}
__device__ __forceinline__ void p0c(KP p) {
    int tid_l = threadIdx.x; asm volatile("" : "+v"(tid_l));
    const int tid = tid_l, lane = tid & 63, wave = tid >> 6;
    const int gw = blockIdx.x * 8 + wave, NGW = gridDim.x * 8;
    unsigned char* ws = p->ws; const float* mod = (const float*)(ws + WS_MOD);
    constexpr int R_IN = DEPTH * BATCH * DIN, R_ALL = R_IN + DEPTH * BATCH * NUP;
    for (int r0 = gw * 4; r0 < R_ALL; r0 += NGW * 4) {
        const bool up = r0 >= R_IN; const int rr = up ? r0 - R_IN : r0, N = up ? NUP : DIN, lb = rr / N, n0 = rr % N, l = lb >> 1;
        const bf16* wt = (const bf16*)(ws + (up ? WS_WUP : WS_WIN)) + ((size_t)lb * N + n0) * D;
        const float* mb = mod + (size_t)lb * NMOD;
        const float* lng = up ? p->ln1_g + l * D : (l ? p->ln2_g + (l - 1) * D : nullptr); const float* lnb = up ? p->ln1_b + l * D : (l ? p->ln2_b + (l - 1) * D : nullptr);
        const float* scl = mb + (up ? 4 * D : D); const float* shf = mb + (up ? 3 * D : 0);
        v4u w[4][2];
#pragma unroll
        for (int i = 0; i < 4; ++i) { w[i][0] = *(const v4u*)(wt + (size_t)i * D + lane * 8); w[i][1] = *(const v4u*)(wt + (size_t)i * D + 512 + lane * 8); }
        float bg[16];
#pragma unroll
        for (int hf = 0; hf < 2; ++hf)
#pragma unroll
            for (int j = 0; j < 8; ++j) { const int c = hf * 512 + lane * 8 + j; const float g = lng ? lng[c] : 1.0f, b = lnb ? lnb[c] : 0.0f, s1 = 1.0f + scl[c];
                bg[hf * 8 + j] = (b * s1 + shf[c]) / (g * s1); }
#pragma unroll
        for (int i = 0; i < 4; ++i) {
            float su = 0.f, sv = 0.f;
#pragma unroll
            for (int hf = 0; hf < 2; ++hf) { const v4u q = w[i][hf];
                const float e0 = bflo(q.x), e1 = bfhi(q.x), e2 = bflo(q.y), e3 = bfhi(q.y), e4 = bflo(q.z), e5 = bfhi(q.z), e6 = bflo(q.w), e7 = bfhi(q.w);
                su += ((e0 + e1) + (e2 + e3)) + ((e4 + e5) + (e6 + e7));
                sv += ((e0 * bg[hf * 8 + 0] + e1 * bg[hf * 8 + 1]) + (e2 * bg[hf * 8 + 2] + e3 * bg[hf * 8 + 3])) + ((e4 * bg[hf * 8 + 4] + e5 * bg[hf * 8 + 5]) + (e6 * bg[hf * 8 + 6] + e7 * bg[hf * 8 + 7])); }
            su = wave_sum(su); sv = wave_sum(sv);
            if (lane == 0) { float* U = (float*)(ws + (up ? WS_UUP : WS_UIN)); float* V = (float*)(ws + (up ? WS_VUP : WS_VIN)); U[(size_t)lb * N + n0 + i] = su; V[(size_t)lb * N + n0 + i] = sv; }
        }
    }
}
__device__ __forceinline__ void final_ln(KP p) {
    int tid_l = threadIdx.x; asm volatile("" : "+v"(tid_l));
    const int tid = tid_l, lane = tid & 63, wave = tid >> 6;
    const int gw = blockIdx.x * 8 + wave, NGW = gridDim.x * 8;
    const bf16* Y = (const bf16*)(p->ws + WS_Y); const float* st = (const float*)(p->ws + WS_STATB);
    const float* g = p->ln2_g + (DEPTH - 1) * D; const float* b = p->ln2_b + (DEPTH - 1) * D; float* out = p->out;
    f32x4 gv[4], bv[4];
#pragma unroll
    for (int hf = 0; hf < 2; ++hf) { gv[2 * hf] = *(const f32x4*)(g + hf * 512 + lane * 8); gv[2 * hf + 1] = *(const f32x4*)(g + hf * 512 + lane * 8 + 4); bv[2 * hf] = *(const f32x4*)(b + hf * 512 + lane * 8); bv[2 * hf + 1] = *(const f32x4*)(b + hf * 512 + lane * 8 + 4); }
    for (int m0 = gw; m0 < M; m0 += 4 * NGW) {
        v4u w[4][2];
#pragma unroll
        for (int r = 0; r < 4; ++r) { w[r][0] = *(const v4u*)(Y + (size_t)(m0 + r * NGW) * D + lane * 8); w[r][1] = *(const v4u*)(Y + (size_t)(m0 + r * NGW) * D + 512 + lane * 8); }
#pragma unroll
        for (int r = 0; r < 4; ++r) { const int m = m0 + r * NGW; float mu, rs; pg8::row_stat(st, m, mu, rs);
#pragma unroll
            for (int hf = 0; hf < 2; ++hf) { const v4u q = w[r][hf];
                const f32x4 y0 = (f32x4){bflo(q.x), bfhi(q.x), bflo(q.y), bfhi(q.y)}, y1 = (f32x4){bflo(q.z), bfhi(q.z), bflo(q.w), bfhi(q.w)};
                *(f32x4*)(out + (size_t)m * D + hf * 512 + lane * 8) = (y0 - mu) * rs * gv[2 * hf] + bv[2 * hf];
                *(f32x4*)(out + (size_t)m * D + hf * 512 + lane * 8 + 4) = (y1 - mu) * rs * gv[2 * hf + 1] + bv[2 * hf + 1]; } }
    }
}

typedef short v4i16_t __attribute__((ext_vector_type(4)));
constexpr int MX_RS = 288;
__device__ __forceinline__ bf16x8 tr_frag(const LAS unsigned char* tile, int row0, int col0, int lane) {
    const int h = lane >> 5, blk = (lane >> 4) & 1, q = (lane & 15) >> 2, pq = lane & 3;
    const LAS unsigned char* a0 = tile + (row0 + 8 * h + q) * MX_RS + (col0 + 16 * blk + 4 * pq) * 2;
    const v4i16_t lo = __builtin_amdgcn_ds_read_tr16_b64_v4i16((LAS v4i16_t*)a0);
    const v4i16_t hi = __builtin_amdgcn_ds_read_tr16_b64_v4i16((LAS v4i16_t*)(a0 + 4 * MX_RS));
    return __builtin_shufflevector(lo, hi, 0, 1, 2, 3, 4, 5, 6, 7);
}
__device__ __forceinline__ unsigned cvtpk(float lo, float hi) { unsigned r; asm volatile("v_cvt_pk_bf16_f32 %0, %1, %2" : "=v"(r) : "v"(lo), "v"(hi)); return r; }
template <int PART> __device__ __forceinline__ void mixer_phase(LAS unsigned char* lds, KP p, int l) {
    int tid_l = threadIdx.x; asm volatile("" : "+v"(tid_l));
    const int tid = tid_l, lane = tid & 63, wid = tid >> 6;
    constexpr int RS = MX_RS, BUFB = 43008, SROW = 144;
    LAS float* ST = (LAS float*)(lds + 2 * BUFB);
    LAS unsigned char* STG = lds + 2 * BUFB + 1024 + wid * (32 * SROW);
    const bf16* PROJ = (const bf16*)(p->ws + WS_PROJ); bf16* MIX = (bf16*)(p->ws + WS_MIX);
    const bf16* PWF = (const bf16*)(p->ws + WS_POOLWT) + (size_t)l * 4 * 128 * 128; const bf16* WTF = (const bf16*)(p->ws + WS_WTRIL) + (size_t)l * 4 * 128 * 128;
    const float* pscale = p->pool_scale + l * 512; const float* lg = p->sgu_ln_g + l * 512; const float* lb = p->sgu_ln_b + l * 512; const float* sb = p->sgu_b + l * 512;
    const int tb = wid >> 1, dbase = (wid & 1) * 2, tl = lane & 31, hh = lane >> 5, t = 32 * tb + tl;
#define MX_LOAD_POOL(g_) do { int tq = tid; asm volatile("" : "+v"(tq)); _Pragma("unroll") for (int k = 0; k < 5; ++k) { const int pc = tq + 512 * k, rr = pc >> 4, cp = pc & 15; raw[k] = (v4u){0u, 0u, 0u, 0u}; \
        if (pc < 2304 && !(first && rr < 16)) raw[k] = *(const v4u*)(PROJ + (size_t)(T0 - 16 + rr) * DIN + (g_) * 128 + cp * 8); } } while (0)
#define MX_LOAD_SGU(h_) do { int tq = tid; asm volatile("" : "+v"(tq)); _Pragma("unroll") for (int k = 0; k < 4; ++k) { const int pc = tq + 512 * k, s_ = pc >> 4, dp_ = pc & 15; \
        raw[k] = *(const v4u*)(proj + (size_t)s_ * DIN + 1024 + (h_) * 128 + dp_ * 8); } } while (0)
#define MX_STORE(colbase_) do { asm volatile("s_waitcnt lgkmcnt(0)" ::: "memory"); _Pragma("unroll") for (int i = 0; i < 4; ++i) { const int row = (lane >> 3) + 8 * i, pc = lane & 7; \
        const v4u v = *(const LAS v4u*)(STG + row * SROW + pc * 16); *(v4u*)(MIX + (size_t)(T0 + 32 * tb + row) * D + (colbase_) + 32 * dbase + pc * 8) = v; } \
        asm volatile("s_waitcnt lgkmcnt(0)" ::: "memory"); } while (0)
    for (int ck = blockIdx.x; ck < M / 128; ck += gridDim.x) {
        const int T0 = ck * 128; const bool first = (ck & 127) == 0;
        const bf16* proj = PROJ + (size_t)T0 * DIN;
        v4u raw[5];
        {
            MX_LOAD_POOL(0);
#pragma unroll 1
            for (int hb = 0; hb < 2; ++hb) {
                v4u rw[8];
#pragma unroll
                for (int i = 0; i < 8; ++i) rw[i] = *(const v4u*)(proj + (size_t)(wid + 8 * (8 * hb + i)) * DIN + 1024 + lane * 8);
#pragma unroll
                for (int i = 0; i < 8; ++i) {
                    const float v0 = bflo(rw[i].x), v1 = bfhi(rw[i].x), v2 = bflo(rw[i].y), v3 = bfhi(rw[i].y), v4 = bflo(rw[i].z), v5 = bfhi(rw[i].z), v6 = bflo(rw[i].w), v7 = bfhi(rw[i].w);
                    const float mean = wave_sum(((v0 + v1) + (v2 + v3)) + ((v4 + v5) + (v6 + v7))) * (1.0f / 512.0f);
                    const float d0 = v0 - mean, d1 = v1 - mean, d2 = v2 - mean, d3 = v3 - mean, d4 = v4 - mean, d5 = v5 - mean, d6 = v6 - mean, d7 = v7 - mean;
                    const float q = wave_sum(((d0 * d0 + d1 * d1) + (d2 * d2 + d3 * d3)) + ((d4 * d4 + d5 * d5) + (d6 * d6 + d7 * d7)));
                    if (lane == 0) { const int s = wid + 8 * (8 * hb + i); ST[2 * s] = mean; ST[2 * s + 1] = 1.0f / sqrtf(q * (1.0f / 512.0f) + LN_EPS); }
                }
            }
        }
#pragma unroll 1
        for (int g = (PART == 2 ? 3 : 0); g < 4; ++g) {
            LAS unsigned char* AT = lds + (g & 1) * BUFB;
            const int w = 2 << g;
            const bf16* wqp = PWF + ((size_t)((g * 4 + dbase) * 4 * 2 * 64 + lane)) * 8;
            bf16x8 wq[2][2];
#pragma unroll
            for (int dbi = 0; dbi < 2; ++dbi)
#pragma unroll
                for (int s2 = 0; s2 < 2; ++s2) wq[dbi][s2] = *(const bf16x8*)(wqp + ((dbi * 4 + 0) * 2 + s2) * 512);
#pragma unroll
            for (int k = 0; k < 5; ++k) { const int pc = tid + 512 * k, rr = pc >> 4, cp = pc & 15; if (pc < 2304) *(LAS v4u*)(AT + rr * RS + cp * 16) = raw[k]; }
            if (g < 3) MX_LOAD_POOL(g + 1); else MX_LOAD_SGU(0);
            __syncthreads();
            const int pos = (ck & 127) * 128 + t, cnt = (pos + 1) < w ? (pos + 1) : w, tt = t + 16; const float inv = 1.0f / (float)cnt, dg = (float)(1 - cnt);
            bf16x8 pm[3];
#pragma unroll
            for (int kk = 0; kk < 3; ++kk) { float e[8];
#pragma unroll
                for (int j = 0; j < 8; ++j) { const int sr = 32 * tb + 16 * kk + 8 * hh + j; e[j] = (sr == tt) ? dg : ((sr < tt && sr > tt - w) ? 1.0f : 0.0f); }
                v4u pk; pk.x = cvtpk(e[0], e[1]); pk.y = cvtpk(e[2], e[3]); pk.z = cvtpk(e[4], e[5]); pk.w = cvtpk(e[6], e[7]); pm[kk] = __builtin_bit_cast(bf16x8, pk); }
            f32x16 acc[2];
#pragma unroll
            for (int i = 0; i < 2; ++i)
#pragma unroll
                for (int r = 0; r < 16; ++r) acc[i][r] = 0.f;
#pragma unroll 1
            for (int cb = 0; cb < 4; ++cb) {
                bf16x8 wn[2][2];
                const int cn = cb < 3 ? cb + 1 : 3;
#pragma unroll
                for (int dbi = 0; dbi < 2; ++dbi)
#pragma unroll
                    for (int s2 = 0; s2 < 2; ++s2) wn[dbi][s2] = *(const bf16x8*)(wqp + ((dbi * 4 + cn) * 2 + s2) * 512);
                f32x16 X;
#pragma unroll
                for (int r = 0; r < 16; ++r) X[r] = 0.f;
#pragma unroll
                for (int kk = 0; kk < 3; ++kk) X = __builtin_amdgcn_mfma_f32_32x32x16_bf16(tr_frag(AT, 32 * tb + 16 * kk, 32 * cb, lane), pm[kk], X, 0, 0, 0);
#pragma unroll
                for (int s2 = 0; s2 < 2; ++s2) { v4u pk; pk.x = cvtpk(X[8 * s2 + 0] * inv, X[8 * s2 + 1] * inv); pk.y = cvtpk(X[8 * s2 + 2] * inv, X[8 * s2 + 3] * inv);
                    pk.z = cvtpk(X[8 * s2 + 4] * inv, X[8 * s2 + 5] * inv); pk.w = cvtpk(X[8 * s2 + 6] * inv, X[8 * s2 + 7] * inv);
                    const bf16x8 xb = __builtin_bit_cast(bf16x8, pk);
#pragma unroll
                    for (int dbi = 0; dbi < 2; ++dbi) acc[dbi] = __builtin_amdgcn_mfma_f32_32x32x16_bf16(wq[dbi][s2], xb, acc[dbi], 0, 0, 0); }
#pragma unroll
                for (int dbi = 0; dbi < 2; ++dbi)
#pragma unroll
                    for (int s2 = 0; s2 < 2; ++s2) wq[dbi][s2] = wn[dbi][s2];
            }
#pragma unroll
            for (int dbi = 0; dbi < 2; ++dbi)
#pragma unroll
                for (int rg = 0; rg < 4; ++rg) { const int d0 = 32 * (dbase + dbi) + 8 * rg + 4 * hh; const f32x4 sc4 = *(const f32x4*)(pscale + g * 128 + d0);
                    v2u o; o.x = cvtpk(acc[dbi][4 * rg + 0] * sc4[0], acc[dbi][4 * rg + 1] * sc4[1]); o.y = cvtpk(acc[dbi][4 * rg + 2] * sc4[2], acc[dbi][4 * rg + 3] * sc4[3]);
                    *(LAS v2u*)(STG + tl * SROW + (32 * dbi + 8 * rg + 4 * hh) * 2) = o; }
            MX_STORE(g * 128);
        }
#pragma unroll 1
        for (int h = 0; h < (PART == 1 ? 0 : 4); ++h) {
            LAS unsigned char* VN = lds + (h & 1) * BUFB;
            bf16x8 aq[8];
#pragma unroll
            for (int ks = 0; ks < 8; ++ks) aq[ks] = *(const bf16x8*)(WTF + ((size_t)(((h * 4 + tb) * 8 + ks) * 64 + lane)) * 8);
            v4u gur[4];
#pragma unroll
            for (int i = 0; i < 4; ++i) { const int row = (lane >> 3) + 8 * i, pc = lane & 7; gur[i] = *(const v4u*)(proj + (size_t)(32 * tb + row) * DIN + 512 + h * 128 + 32 * dbase + pc * 8); }
            const float bias = sb[h * 128 + t];
#pragma unroll
            for (int k = 0; k < 4; ++k) { const int pc = tid + 512 * k, s = pc >> 4, dp = pc & 15; const float mean = ST[2 * s], rstd = ST[2 * s + 1];
                const f32x4 g0 = *(const f32x4*)(lg + h * 128 + dp * 8), g1 = *(const f32x4*)(lg + h * 128 + dp * 8 + 4), b0 = *(const f32x4*)(lb + h * 128 + dp * 8), b1 = *(const f32x4*)(lb + h * 128 + dp * 8 + 4);
                const v4u rk = raw[k]; v4u o;
                o.x = cvtpk((bflo(rk.x) - mean) * rstd * g0[0] + b0[0], (bfhi(rk.x) - mean) * rstd * g0[1] + b0[1]); o.y = cvtpk((bflo(rk.y) - mean) * rstd * g0[2] + b0[2], (bfhi(rk.y) - mean) * rstd * g0[3] + b0[3]);
                o.z = cvtpk((bflo(rk.z) - mean) * rstd * g1[0] + b1[0], (bfhi(rk.z) - mean) * rstd * g1[1] + b1[1]); o.w = cvtpk((bflo(rk.w) - mean) * rstd * g1[2] + b1[2], (bfhi(rk.w) - mean) * rstd * g1[3] + b1[3]);
                *(LAS v4u*)(VN + s * RS + dp * 16) = o; }
            if (h < 3) MX_LOAD_SGU(h + 1);
#pragma unroll
            for (int i = 0; i < 4; ++i) { const int row = (lane >> 3) + 8 * i, pc = lane & 7; *(LAS v4u*)(STG + row * SROW + pc * 16) = gur[i]; }
            __syncthreads();
            v2u guq[2][4];
#pragma unroll
            for (int dbi = 0; dbi < 2; ++dbi)
#pragma unroll
                for (int rg = 0; rg < 4; ++rg) guq[dbi][rg] = *(const LAS v2u*)(STG + tl * SROW + (32 * dbi + 8 * rg + 4 * hh) * 2);
            f32x16 acc[2];
#pragma unroll
            for (int i = 0; i < 2; ++i)
#pragma unroll
                for (int r = 0; r < 16; ++r) acc[i][r] = 0.f;
            const int nks = 2 * tb + 2;
#pragma unroll
            for (int ks = 0; ks < 8; ++ks) if (ks < nks) {
#pragma unroll
                for (int dbi = 0; dbi < 2; ++dbi) acc[dbi] = __builtin_amdgcn_mfma_f32_32x32x16_bf16(tr_frag(VN, 16 * ks, 32 * (dbase + dbi), lane), aq[ks], acc[dbi], 0, 0, 0);
            }
            asm volatile("s_waitcnt lgkmcnt(0)" ::: "memory");
#pragma unroll
            for (int dbi = 0; dbi < 2; ++dbi)
#pragma unroll
                for (int rg = 0; rg < 4; ++rg) { const v2u gu = guq[dbi][rg];
                    v2u o; o.x = cvtpk(bflo(gu.x) * (acc[dbi][4 * rg + 0] + bias), bfhi(gu.x) * (acc[dbi][4 * rg + 1] + bias)); o.y = cvtpk(bflo(gu.y) * (acc[dbi][4 * rg + 2] + bias), bfhi(gu.y) * (acc[dbi][4 * rg + 3] + bias));
                    *(LAS v2u*)(STG + tl * SROW + (32 * dbi + 8 * rg + 4 * hh) * 2) = o; }
            MX_STORE(512 + h * 128);
        }
        __syncthreads();
    }
#undef MX_LOAD_POOL
#undef MX_LOAD_SGU
#undef MX_STORE
}

__device__ __forceinline__ void fixup_rows(KP p, int l, int pmg) {
    const float* HG = (const float*)(p->ws + WS_HEADG) + (size_t)pmg * 2 * FF; const float* HV = (const float*)(p->ws + WS_HEADV) + (size_t)pmg * 2 * FF;
    const float* TG = (const float*)(p->ws + WS_TAILG) + (size_t)(pmg - 1) * 2 * FF;
    const float* cw = p->conv_w + (size_t)l * 3 * FF; const float* cb = p->conv_b + (size_t)l * FF;
    bf16* HID = (bf16*)(p->ws + WS_HID) + (size_t)pmg * 256 * FF;
    int tid_l = threadIdx.x; asm volatile("" : "+v"(tid_l));
    for (int f = tid_l * 4; f < FF; f += 2048) {
        const f32x4 g0 = *(const f32x4*)(HG + f), g1 = *(const f32x4*)(HG + FF + f), tm2 = *(const f32x4*)(TG + f), tm1 = *(const f32x4*)(TG + FF + f);
        const f32x4 v0 = *(const f32x4*)(HV + f), v1 = *(const f32x4*)(HV + FF + f);
        const f32x4 w0 = *(const f32x4*)(cw + f), w1 = *(const f32x4*)(cw + FF + f), w2 = *(const f32x4*)(cw + 2 * FF + f), bb = *(const f32x4*)(cb + f);
        const f32x4 p0 = bb + w0 * tm2 + w1 * tm1 + w2 * g0, p1 = bb + w0 * tm1 + w1 * g0 + w2 * g1;
        v2u o0, o1;
        o0.x = pk2(pg8::gelu_t(p0[0]) * v0[0], pg8::gelu_t(p0[1]) * v0[1]); o0.y = pk2(pg8::gelu_t(p0[2]) * v0[2], pg8::gelu_t(p0[3]) * v0[3]);
        o1.x = pk2(pg8::gelu_t(p1[0]) * v1[0], pg8::gelu_t(p1[1]) * v1[1]); o1.y = pk2(pg8::gelu_t(p1[2]) * v1[2], pg8::gelu_t(p1[3]) * v1[3]);
        *(v2u*)(HID + f) = o0; *(v2u*)(HID + FF + f) = o1;
    }
    asm volatile("s_waitcnt vmcnt(0)" ::: "memory");
    __syncthreads();
    __builtin_amdgcn_fence(__ATOMIC_ACQUIRE, "agent");
    asm volatile("s_waitcnt vmcnt(0)" ::: "memory");
    __syncthreads();
}

#define XB_TMO      128
#define XB_XCNT(j)  (256  + 64 * (j))
#define XB_XSUB(j)  (1280 + 64 * (j))
#define XB_XGEN(j)  (2304 + 64 * (j))
#define XB_TOP      3328
#define XB_TOPGEN   3392
#define XCD_BAR_WORDS 3456
#define XB_SPIN_CAP (1u << 18)

__device__ __forceinline__ unsigned xb_ld(unsigned* p)              { return __hip_atomic_load(p, __ATOMIC_RELAXED, __HIP_MEMORY_SCOPE_AGENT); }
__device__ __forceinline__ unsigned xb_add(unsigned* p, unsigned v) { return __hip_atomic_fetch_add(p, v, __ATOMIC_RELAXED, __HIP_MEMORY_SCOPE_AGENT); }
__device__ __forceinline__ unsigned xb_xcc_id() { return (unsigned)__builtin_amdgcn_s_getreg((3 << 11) | 20) & 0xFu; }
#define XB_SPIN(cond, bar) do { unsigned _sp = 0; while (cond) { __builtin_amdgcn_s_sleep(1); \
    if ((++_sp & 255u) == 0u) { if (xb_ld(&(bar)[XB_TMO])) break; if (_sp > XB_SPIN_CAP) { atomicAdd(&(bar)[XB_TMO], 1u); break; } } } } while (0)

struct XcdBarrier {
    unsigned* bar; unsigned x;
    volatile LAS unsigned* st;
};

__device__ __forceinline__ XcdBarrier xcd_barrier_post(unsigned* bar, volatile LAS unsigned* st) {
    XcdBarrier b; b.bar = bar; b.x = xb_xcc_id(); b.st = st;
    if (threadIdx.x == 0) (void)xb_add(&bar[XB_XCNT(b.x)], 1u);
    return b;
}
__device__ __forceinline__ void xcd_barrier_complete(unsigned* bar, unsigned x, unsigned& nloc, unsigned& nx) {
    const unsigned G = gridDim.x * gridDim.y * gridDim.z;
    unsigned sum, cnt, mine, sp = 0u;
    for (;;) {
        sum = 0u; cnt = 0u; mine = 0u;
#pragma unroll
        for (unsigned j = 0; j < 16; ++j) { const unsigned c = xb_ld(&bar[XB_XCNT(j)]); sum += c; cnt += (c > 0u) ? 1u : 0u; mine = (j == x) ? c : mine; }
        if (sum == G) break;
        __builtin_amdgcn_s_sleep(1);
        if ((++sp & 255u) == 0u) { if (xb_ld(&bar[XB_TMO])) break; if (sp > XB_SPIN_CAP) { atomicAdd(&bar[XB_TMO], 1u); break; } }
    }
    nloc = mine > 0u ? mine : 1u; nx = cnt > 0u ? cnt : 1u;
}

__device__ __forceinline__ void xcd_barrier(const XcdBarrier& b) {
    asm volatile("s_waitcnt vmcnt(0)" ::: "memory");
    __syncthreads();
    if (threadIdx.x == 0) {
        const unsigned xq = xb_xcc_id();
        unsigned* bar = b.bar; asm volatile("" : "+s"(bar));
        __builtin_amdgcn_s_waitcnt(0);
        unsigned nloc = b.st[0], nx = b.st[1];
        if (nloc == 0u) { xcd_barrier_complete(bar, xq, nloc, nx); b.st[0] = nloc; b.st[1] = nx; }
        const unsigned old = xb_add(&bar[XB_XSUB(xq)], 1u);
        const unsigned gen = old / nloc;
        if (old + 1u == (gen + 1u) * nloc) {
            __builtin_amdgcn_fence(__ATOMIC_RELEASE, "agent");
            asm volatile("s_waitcnt vmcnt(0)" ::: "memory");
            const unsigned og = xb_add(&bar[XB_TOP], 1u);
            const unsigned tg = og / nx;
            if (og + 1u == (tg + 1u) * nx) xb_add(&bar[XB_TOPGEN], 1u);
            else XB_SPIN(xb_ld(&bar[XB_TOPGEN]) == tg, bar);
            __builtin_amdgcn_fence(__ATOMIC_ACQUIRE, "agent");
            xb_add(&bar[XB_XGEN(xq)], 1u);
            asm volatile("s_waitcnt vmcnt(0)" ::: "memory");
        } else {
            XB_SPIN(xb_ld(&bar[XB_XGEN(xq)]) == gen, bar);
            __builtin_amdgcn_fence(__ATOMIC_ACQUIRE, "agent");
            asm volatile("s_waitcnt vmcnt(0)" ::: "memory");
        }
    }
    __syncthreads();
}

__global__ void __launch_bounds__(512, 2) mk_fwd(Params p_arg) {
    extern __shared__ __attribute__((aligned(16))) unsigned char lds_raw[];
    cg::grid_group grid = cg::this_grid();
    LAS unsigned char* lds = (LAS unsigned char*)lds_raw;
    volatile LAS unsigned* MISC = (volatile LAS unsigned*)(lds + MISC_OFF);
    if (threadIdx.x < 8) MISC[threadIdx.x] = 0u;
    __syncthreads();
    p0a(lds, kparams());
    grid.sync();
    XcdBarrier bar;
    { KP p = kparams(); bar = xcd_barrier_post((unsigned*)(p->ws + WS_CTL) + CW_BAR, MISC);
      if (threadIdx.x == 0) { const unsigned xcc = xb_xcc_id(); MISC[2] = xb_add((unsigned*)(p->ws + WS_CTL) + CW_RANK + 64 * (xcc & 15u), 1u); MISC[3] = xcc; } }
#define GSYNC() xcd_barrier(bar)
#ifndef NO_P0
    p0b(lds, kparams());
#endif
#ifdef REP_P0
    GSYNC(); p0b(lds, kparams());
#endif
    GSYNC();
    { KP p = kparams(); if (threadIdx.x == 0) { bool ok = MISC[3] < 8u;
#pragma unroll
        for (int j = 0; j < 8; ++j) ok = ok && xb_ld((unsigned*)(p->ws + WS_CTL) + CW_RANK + 64 * j) == gridDim.x / 8u;
        MISC[4] = ok ? MISC[2] * 8u + MISC[3] : blockIdx.x; }
      __syncthreads(); }
    const int cidx_s = __builtin_amdgcn_readfirstlane((int)MISC[4]);
#define CIDX() cidx_s
#ifndef NO_P0
    p0c(kparams());
#endif
    GSYNC();
#pragma unroll 1
    for (int l = 0; l < DEPTH; ++l) {
#ifndef NO_P1
        {   KP p = kparams(); unsigned char* ws = p->ws; const int G = gridDim.x;
            pg8::Gemm g{(const bf16*)(ws + WS_Y), (const bf16*)(ws + WS_WIN) + (size_t)l * 2 * DIN * D, M, DIN, D, 64, (size_t)DIN * D * 2}; pg8::StaticOrder S; S.init(M, DIN, G, CIDX());
            pg8::EpiProj E{(bf16*)(ws + WS_PROJ), DIN, (const float*)(ws + WS_STATB), (const float*)(ws + WS_UIN) + (size_t)l * 2 * DIN, (const float*)(ws + WS_VIN) + (size_t)l * 2 * DIN, l == 0 ? 1 : 0};
            pg8::gemm_phase<pg8::EpiProj, pg8::StaticOrder, true, true>(lds, g, S, E);
#ifdef REP_P1
            GSYNC(); pg8::gemm_phase<pg8::EpiProj, pg8::StaticOrder, true, true>(lds, g, S, E);
#endif
#ifdef REP_P1N
            GSYNC(); { pg8::EpiNull EN{(float*)(ws + 400 * MiB)}; pg8::gemm_phase<pg8::EpiNull, pg8::StaticOrder, true, true>(lds, g, S, EN); }
#endif
        }
#endif
        GSYNC();
#ifndef NO_P2
        mixer_phase<0>(lds, kparams(), l);
#ifdef REP_P2
        GSYNC(); mixer_phase<0>(lds, kparams(), l);
#endif
#endif
        GSYNC();
#ifndef NO_P3
        {   KP p = kparams(); unsigned char* ws = p->ws; const int G = gridDim.x;
            pg8::Gemm g{(const bf16*)(ws + WS_MIX), (const bf16*)(ws + WS_WOUT) + (size_t)l * D * D, M, D, D, 0, 0}; pg8::StaticOrder S; S.init(M, D, G, CIDX());
            const float* modl = (const float*)(ws + WS_MOD) + (size_t)l * 2 * NMOD;
            if (l == 0) { pg8::EpiY<true> E{p->x, (bf16*)(ws + WS_Y), D, modl, 2 * D, nullptr, nullptr, nullptr, (float*)(ws + WS_STATA)};
                pg8::gemm_phase<pg8::EpiY<true>, pg8::StaticOrder, true, true>(lds, g, S, E); }
            else { pg8::EpiY<false> E{nullptr, (bf16*)(ws + WS_Y), D, modl, 2 * D, p->ln2_g + (l - 1) * D, p->ln2_b + (l - 1) * D, (const float*)(ws + WS_STATB), (float*)(ws + WS_STATA)};
                pg8::gemm_phase<pg8::EpiY<false>, pg8::StaticOrder, true, true>(lds, g, S, E); }
        }
#endif
        GSYNC();
#ifndef NO_P4
        {   KP p = kparams(); unsigned char* ws = p->ws; const int G = gridDim.x;
            pg8::Gemm g{(const bf16*)(ws + WS_Y), (const bf16*)(ws + WS_WUP) + (size_t)l * 2 * NUP * D, M, NUP, D, 64, (size_t)NUP * D * 2}; pg8::StaticOrder S; S.init(M, NUP, G, CIDX());
            pg8::EpiConv E{(bf16*)(ws + WS_HID), p->conv_w + (size_t)l * 3 * FF, p->conv_b + (size_t)l * FF, (float*)(ws + WS_HEADG), (float*)(ws + WS_HEADV), (float*)(ws + WS_TAILG), FF,
                           (const float*)(ws + WS_STATA), (const float*)(ws + WS_UUP) + (size_t)l * 2 * NUP, (const float*)(ws + WS_VUP) + (size_t)l * 2 * NUP};
            pg8::gemm_phase<pg8::EpiConv, pg8::StaticOrder, true, true>(lds, g, S, E);
#ifdef REP_P4
            GSYNC(); pg8::gemm_phase<pg8::EpiConv, pg8::StaticOrder, true, true>(lds, g, S, E);
#endif
#ifdef REP_P4N
            GSYNC(); { pg8::EpiNull EN{(float*)(ws + 400 * MiB)}; pg8::gemm_phase<pg8::EpiNull, pg8::StaticOrder, true, true>(lds, g, S, EN); }
#endif
        }
#endif
        GSYNC();
#ifndef NO_P5
        {   pg8::StaticOrder S; S.init(M, D, (int)gridDim.x, CIDX());
#pragma unroll 1
            for (int i = 0; i < 2; ++i) { pg8::Unit u0; if (S.next(i, u0) && (u0.pm & 63) != 0) fixup_rows(kparams(), l, u0.pm); }
            KP p = kparams(); unsigned char* ws = p->ws;
            pg8::Gemm g{(const bf16*)(ws + WS_HID), (const bf16*)(ws + WS_WDN) + (size_t)l * D * FF, M, D, FF, 0, 0};
            const float* modl = (const float*)(ws + WS_MOD) + (size_t)l * 2 * NMOD;
            pg8::EpiY<false> E{nullptr, (bf16*)(ws + WS_Y), D, modl, 5 * D, p->ln1_g + l * D, p->ln1_b + l * D, (const float*)(ws + WS_STATA), (float*)(ws + WS_STATB)};
            pg8::gemm_phase<pg8::EpiY<false>, pg8::StaticOrder, true, true>(lds, g, S, E);
        }
#endif
        GSYNC();
#ifdef REP_SYNC
        GSYNC(); GSYNC(); GSYNC(); GSYNC(); GSYNC();
#endif
    }
#ifndef NO_P0
    final_ln(kparams());
#endif
}

extern "C" void kernel_launch(void* const* d_in, const int* in_sizes, int n_in, void* d_out, int out_size, void* d_ws, size_t ws_size, hipStream_t stream) {
    static int state = 0;
    if (state == 0) {
        state = 1;
        if (n_in != 20 || out_size != M * D || ws_size < WS_END) { fprintf(stderr, "kernel_launch: unexpected sizes n_in %d out %d ws %zu\n", n_in, out_size, ws_size); state = -1; }
        int dev = 0, cus = 0, per_cu = 0;
        (void)hipGetDevice(&dev); (void)hipDeviceGetAttribute(&cus, hipDeviceAttributeMultiprocessorCount, dev);
        if (hipFuncSetAttribute((const void*)mk_fwd, hipFuncAttributeMaxDynamicSharedMemorySize, LDS_BYTES) != hipSuccess) { fprintf(stderr, "kernel_launch: hipFuncSetAttribute failed\n"); state = -1; }
        (void)hipOccupancyMaxActiveBlocksPerMultiprocessor(&per_cu, (const void*)mk_fwd, 512, LDS_BYTES);
        if (cus * per_cu < 256) { fprintf(stderr, "kernel_launch: need 256 co-resident workgroups, device offers %d x %d\n", cus, per_cu); state = -1; }
        (void)hipGetLastError();
    }
    if (state < 0) return;
    Params p{};
    const float** pp = (const float**)&p;
    for (int i = 0; i < 20; ++i) pp[i] = (const float*)d_in[i];
    p.out = (float*)d_out; p.ws = (unsigned char*)d_ws;
    void* args[] = {&p};
    hipError_t e = hipLaunchCooperativeKernel((const void*)mk_fwd, dim3(256), dim3(512), args, LDS_BYTES, stream);
    if (e != hipSuccess) fprintf(stderr, "kernel_launch: cooperative launch failed: %s\n", hipGetErrorString(e));
}
```
